# Optimizing an MI355X kernel written in HIP

```python
import math
import jax, jax.numpy as jnp
from jax import lax
import numpy as np

D_MODEL = 1024
BATCH = 16
SEQ = 2048
DEPTH = 4

GRID_W = 64
CTX_LEN = 256
N_MIXERS = 3
N_LAYERS_A = (DEPTH + 2) // 3
N_LAYERS_B = (DEPTH + 1) // 3
N_LAYERS_C = DEPTH // 3
MLP_HIDDEN = 4 * D_MODEL
NORM_EPS = 1e-6
ROPE_THETA = 10000.0
Q_BLOCK = 128
N_MOD = 6
DA_HEAD_DIM = 64
DA_HEADS = D_MODEL // (2 * DA_HEAD_DIM)
DA_SCALE = DA_HEAD_DIM ** -0.5
MLA_HEADS = 16
MLA_Q_LORA = 256
MLA_KV_LORA = 128
MLA_NOPE = 64
MLA_ROPE = 32
MLA_V = 64
MLA_SCALE = (MLA_NOPE + MLA_ROPE) ** -0.5
SC_WIDTH = 3

kernel_name = "hybrid_diffattn_mla_shortconv_dit"


def rms_norm(x, g):
    xf = x.astype(jnp.float32)
    y = xf * lax.rsqrt(jnp.mean(xf * xf, axis=-1, keepdims=True) + NORM_EPS)
    return (y * g.astype(jnp.float32)).astype(x.dtype)


def modulate(x, shift, scale):
    return x * (1 + scale) + shift


def axial_rope_tables(row, col, rot_dim):
    quarter = rot_dim // 4
    inv_freq = ROPE_THETA ** (-jnp.arange(quarter, dtype=jnp.float32) / quarter)
    ang = jnp.concatenate([row[:, None] * inv_freq, col[:, None] * inv_freq], axis=-1)
    return jnp.cos(ang), jnp.sin(ang)


def apply_rope(x, cos, sin):
    half = x.shape[-1] // 2
    xf = x.astype(jnp.float32)
    x1, x2 = xf[..., :half], xf[..., half:]
    return jnp.concatenate([x1 * cos - x2 * sin, x2 * cos + x1 * sin], axis=-1).astype(x.dtype)


def sweep_query_blocks(fn, qs):
    b, s = qs[0].shape[:2]
    nblk = s // Q_BLOCK
    blocks = tuple(jnp.moveaxis(q.reshape((b, nblk, Q_BLOCK) + q.shape[2:]), 1, 0) for q in qs)
    out = lax.map(lambda qb: fn(*qb), blocks)
    return jnp.moveaxis(out, 0, 1).reshape(b, s, -1)


def _diff_attend(q, k, v, lam, subln_g, lambda_init):
    b, nq = q.shape[0], q.shape[1]
    s = jnp.einsum('bqhd,bkhd->bhqk', q, k, preferred_element_type=jnp.float32) * DA_SCALE
    p = jax.nn.softmax(s, axis=-1).reshape(b, DA_HEADS, 2, nq, -1)
    a = p[:, :, 0] - lam * p[:, :, 1]
    o = jnp.einsum('bhqk,bkhe->bqhe', a.astype(v.dtype), v)
    o = rms_norm(o, subln_g) * (1.0 - lambda_init)
    return o.reshape(b, nq, DA_HEADS * 2 * DA_HEAD_DIM)


def diff_attention(a_lat, a_ctx, w_qkv, lam_vecs, subln_g, w_out, lambda_init, cos, sin, ctx_out):
    def project(a):
        b, n, _ = a.shape
        q, k, v = jnp.split(a @ w_qkv, 3, axis=-1)
        return (q.reshape(b, n, 2 * DA_HEADS, DA_HEAD_DIM),
                k.reshape(b, n, 2 * DA_HEADS, DA_HEAD_DIM),
                v.reshape(b, n, DA_HEADS, 2 * DA_HEAD_DIM))

    q_l, k_l, v_l = project(a_lat)
    q_c, k_c, v_c = project(a_ctx)
    cs, sn = cos[:, None, :], sin[:, None, :]
    q_l = apply_rope(q_l, cs, sn)
    k_l = apply_rope(k_l, cs, sn)
    lv = lam_vecs.astype(jnp.float32)
    lam = jnp.exp(jnp.sum(lv[0] * lv[1])) - jnp.exp(jnp.sum(lv[2] * lv[3])) + lambda_init
    k_all = jnp.concatenate([k_c, k_l], axis=1)
    v_all = jnp.concatenate([v_c, v_l], axis=1)
    y_lat = sweep_query_blocks(
        lambda qb: _diff_attend(qb, k_all, v_all, lam, subln_g, lambda_init), (q_l,)) @ w_out
    y_ctx = _diff_attend(q_c, k_c, v_c, lam, subln_g, lambda_init) @ w_out if ctx_out else None
    return y_lat, y_ctx


def _mla_attend(qn, qr, kn, kr, v):
    s = (jnp.einsum('bqhd,bkhd->bhqk', qn, kn, preferred_element_type=jnp.float32)
         + jnp.einsum('bqhd,bkd->bhqk', qr, kr, preferred_element_type=jnp.float32)) * MLA_SCALE
    p = jax.nn.softmax(s, axis=-1).astype(v.dtype)
    o = jnp.einsum('bhqk,bkhe->bqhe', p, v)
    return o.reshape(o.shape[0], o.shape[1], MLA_HEADS * MLA_V)


def mla_attention(a_lat, a_ctx, w_down, q_norm_g, w_uq, kv_norm_g, w_ukv, w_out, cos, sin, ctx_out):
    def project(a):
        b, n, _ = a.shape
        cq, ckv, kr = jnp.split(a @ w_down, [MLA_Q_LORA, MLA_Q_LORA + MLA_KV_LORA], axis=-1)
        q = (rms_norm(cq, q_norm_g) @ w_uq).reshape(b, n, MLA_HEADS, MLA_NOPE + MLA_ROPE)
        kv = (rms_norm(ckv, kv_norm_g) @ w_ukv).reshape(b, n, MLA_HEADS, MLA_NOPE + MLA_V)
        return q[..., :MLA_NOPE], q[..., MLA_NOPE:], kv[..., :MLA_NOPE], kr, kv[..., MLA_NOPE:]

    qn_l, qr_l, kn_l, kr_l, v_l = project(a_lat)
    qn_c, qr_c, kn_c, kr_c, v_c = project(a_ctx)
    qr_l = apply_rope(qr_l, cos[:, None, :], sin[:, None, :])
    kr_l = apply_rope(kr_l, cos, sin)
    kn_all = jnp.concatenate([kn_c, kn_l], axis=1)
    kr_all = jnp.concatenate([kr_c, kr_l], axis=1)
    v_all = jnp.concatenate([v_c, v_l], axis=1)
    y_lat = sweep_query_blocks(
        lambda qn_b, qr_b: _mla_attend(qn_b, qr_b, kn_all, kr_all, v_all), (qn_l, qr_l)) @ w_out
    y_ctx = _mla_attend(qn_c, qr_c, kn_c, kr_c, v_c) @ w_out if ctx_out else None
    return y_lat, y_ctx


def short_conv(a, w_in, conv_w, w_out):
    d = a.shape[-1]
    b_gate, c_gate, h = jnp.split(a @ w_in, 3, axis=-1)
    u = lax.conv_general_dilated(c_gate * h, conv_w[:, None, :].astype(a.dtype),
                                 window_strides=(1,), padding=((SC_WIDTH // 2, SC_WIDTH // 2),),
                                 dimension_numbers=('NWC', 'WIO', 'NWC'), feature_group_count=d)
    return (b_gate * u) @ w_out


def squared_relu_mlp(a, w_in, w_out):
    return jnp.square(jax.nn.relu(a @ w_in)) @ w_out


def setup_inputs(seed: int = 0) -> dict:
    key = jax.random.key(seed)
    ks = iter(jax.random.split(key, 32))
    D = D_MODEL

    def nrm(shape, scale=1.0):
        return jax.random.normal(next(ks), shape, jnp.float32) * scale

    def w(shape, fan_in, scale=1.0):
        return nrm(shape, scale * fan_in ** -0.5)

    def gain(shape):
        return 1.0 + nrm(shape, 0.02)

    return {
        "x": nrm((BATCH, SEQ, D)),
        "c": nrm((BATCH, D)),
        "ctx": nrm((BATCH, CTX_LEN, D)),
        "c_ctx": nrm((D,)),
        "w_ada": w((DEPTH, D, N_MOD * D), D, 0.5),
        "b_ada": nrm((DEPTH, N_MOD * D), 0.01),
        "norm_g": gain((DEPTH, 4, D)),
        "w_mlp_in": w((DEPTH, D, MLP_HIDDEN), D),
        "w_mlp_out": w((DEPTH, MLP_HIDDEN, D), MLP_HIDDEN),
        "w_da_qkv": w((N_LAYERS_A, D, 3 * 2 * DA_HEADS * DA_HEAD_DIM), D),
        "da_lambda": nrm((N_LAYERS_A, 4, DA_HEAD_DIM), 0.1),
        "da_subln": gain((N_LAYERS_A, 2 * DA_HEAD_DIM)),
        "w_da_out": w((N_LAYERS_A, 2 * DA_HEADS * DA_HEAD_DIM, D), 2 * DA_HEADS * DA_HEAD_DIM),
        "w_mla_down": w((N_LAYERS_B, D, MLA_Q_LORA + MLA_KV_LORA + MLA_ROPE), D),
        "mla_q_norm": gain((N_LAYERS_B, MLA_Q_LORA)),
        "w_mla_uq": w((N_LAYERS_B, MLA_Q_LORA, MLA_HEADS * (MLA_NOPE + MLA_ROPE)), MLA_Q_LORA),
        "mla_kv_norm": gain((N_LAYERS_B, MLA_KV_LORA)),
        "w_mla_ukv": w((N_LAYERS_B, MLA_KV_LORA, MLA_HEADS * (MLA_NOPE + MLA_V)), MLA_KV_LORA),
        "w_mla_out": w((N_LAYERS_B, MLA_HEADS * MLA_V, D), MLA_HEADS * MLA_V),
        "w_sc_in": w((N_LAYERS_C, D, 3 * D), D),
        "sc_conv": w((N_LAYERS_C, SC_WIDTH, D), SC_WIDTH),
        "w_sc_out": w((N_LAYERS_C, D, D), D),
    }


def reference(x, c, ctx, c_ctx, w_ada, b_ada, norm_g, w_mlp_in, w_mlp_out,
              w_da_qkv, da_lambda, da_subln, w_da_out,
              w_mla_down, mla_q_norm, w_mla_uq, mla_kv_norm, w_mla_ukv, w_mla_out,
              w_sc_in, sc_conv, w_sc_out):
    n_lat = x.shape[1]
    rows = n_lat // GRID_W
    row = jnp.repeat(jnp.arange(rows, dtype=jnp.float32), GRID_W)
    col = jnp.tile(jnp.arange(GRID_W, dtype=jnp.float32), rows)
    cos_da, sin_da = axial_rope_tables(row, col, DA_HEAD_DIM)
    cos_mla, sin_mla = axial_rope_tables(row, col, MLA_ROPE)

    silu_c = jax.nn.silu(c)
    silu_cc = jax.nn.silu(c_ctx)
    h_lat, h_ctx = x, ctx
    for i in range(DEPTH):
        kind, j = i % N_MIXERS, i // N_MIXERS
        ctx_out = i < DEPTH - 1
        g = norm_g[i]
        m_lat = jnp.split((silu_c @ w_ada[i] + b_ada[i])[:, None, :], N_MOD, axis=-1)
        m_ctx = jnp.split(silu_cc @ w_ada[i] + b_ada[i], N_MOD, axis=-1)

        a_lat = modulate(rms_norm(h_lat, g[0]), m_lat[0], m_lat[1])
        if kind == 0:
            a_ctx = modulate(rms_norm(h_ctx, g[0]), m_ctx[0], m_ctx[1])
            lambda_init = 0.8 - 0.6 * math.exp(-0.3 * i)
            y_lat, y_ctx = diff_attention(a_lat, a_ctx, w_da_qkv[j], da_lambda[j], da_subln[j],
                                          w_da_out[j], lambda_init, cos_da, sin_da, ctx_out)
        elif kind == 1:
            a_ctx = modulate(rms_norm(h_ctx, g[0]), m_ctx[0], m_ctx[1])
            y_lat, y_ctx = mla_attention(a_lat, a_ctx, w_mla_down[j], mla_q_norm[j], w_mla_uq[j],
                                         mla_kv_norm[j], w_mla_ukv[j], w_mla_out[j],
                                         cos_mla, sin_mla, ctx_out)
        else:
            y_lat = short_conv(a_lat, w_sc_in[j], sc_conv[j], w_sc_out[j])
            if ctx_out:
                a_ctx = modulate(rms_norm(h_ctx, g[0]), m_ctx[0], m_ctx[1])
                y_ctx = short_conv(a_ctx, w_sc_in[j], sc_conv[j], w_sc_out[j])

        h_lat = h_lat + m_lat[2] * rms_norm(y_lat, g[1])
        f_lat = squared_relu_mlp(modulate(rms_norm(h_lat, g[2]), m_lat[3], m_lat[4]), w_mlp_in[i], w_mlp_out[i])
        h_lat = h_lat + m_lat[5] * rms_norm(f_lat, g[3])
        if ctx_out:
            h_ctx = h_ctx + m_ctx[2] * rms_norm(y_ctx, g[1])
            f_ctx = squared_relu_mlp(modulate(rms_norm(h_ctx, g[2]), m_ctx[3], m_ctx[4]), w_mlp_in[i], w_mlp_out[i])
            h_ctx = h_ctx + m_ctx[5] * rms_norm(f_ctx, g[3])
    return h_lat
```

```cpp
#include <hip/hip_runtime.h>
#include <hip/hip_cooperative_groups.h>
#include <cstdio>
namespace cg = cooperative_groups;
#ifndef EN_PREP
#define EN_PREP 1
#endif
#ifndef EN_ROW
#define EN_ROW 1
#endif
#ifndef EN_DA
#define EN_DA 1
#endif
#ifndef EN_MLA
#define EN_MLA 1
#endif
#ifndef EN_MISC
#define EN_MISC 1
#endif
#ifndef EN_GEMM
#define EN_GEMM 1
#endif

#define LAS __attribute__((address_space(3)))
typedef unsigned short bf16_t;
typedef short bf16x8 __attribute__((ext_vector_type(8)));
typedef short s16x4 __attribute__((ext_vector_type(4)));
typedef float f32x4 __attribute__((ext_vector_type(4)));
typedef float f32x16 __attribute__((ext_vector_type(16)));
typedef unsigned u32x4 __attribute__((ext_vector_type(4)));
typedef unsigned u32x2 __attribute__((ext_vector_type(2)));

constexpr int DM = 1024, NB = 16, SEQ = 2048, CTX = 256, DEPTH = 4, HID = 4096;
constexpr int TC = NB * CTX, TL = NB * SEQ, TT = TC + TL;
constexpr float EPS = 1e-6f;
constexpr size_t MiB = 1u << 20;
constexpr size_t WS_MOD = 0;
constexpr size_t WS_TAB = 2 * MiB;
constexpr size_t TAB_CSDA = 0, TAB_SNDA = 262144, TAB_CSMLA = 524288, TAB_SNMLA = 655360;
constexpr size_t WS_HC = 3 * MiB;
constexpr size_t W_MLP_IN = 19 * MiB, W_MLP_OUT = 51 * MiB, W_DA_QKV = 83 * MiB, W_DA_OUT = 95 * MiB, W_MLA_DOWN = 99 * MiB,
                 W_MLA_UP = 100 * MiB, W_MLA_OUT = 103 * MiB, W_SC_IN = 105 * MiB, W_SC_OUT = 111 * MiB;
constexpr size_t WS_A = 113 * MiB;
constexpr size_t WS_BIG = 185 * MiB;
constexpr size_t BIG_SCR = 216 * MiB;
constexpr size_t BIG_A2 = 256 * MiB, BIG_KR = 284 * MiB;
constexpr size_t WS_END = 473 * MiB;
constexpr int LDS_BYTES = 131072;

struct Params { const float* in[22]; float* out; unsigned char* ws; int ph_lo, ph_hi, coop, pad; };

__device__ __forceinline__ unsigned cvt_pk_bf16(float lo, float hi) { unsigned r; asm("v_cvt_pk_bf16_f32 %0, %1, %2" : "=v"(r) : "v"(lo), "v"(hi)); return r; }
__device__ __forceinline__ float bf_lo(unsigned w) { return __uint_as_float(w << 16); }
__device__ __forceinline__ float bf_hi(unsigned w) { return __uint_as_float(w & 0xffff0000u); }
__device__ __forceinline__ float wave_sum(float v) {
#pragma unroll
    for (int o = 1; o < 64; o <<= 1) v += __shfl_xor(v, o);
    return v;
}

namespace pg8 {
constexpr int BM = 256, BK = 64, HALF = 128, HTB = HALF * BK * 2, STAGE_BYTES = 8 * HTB, NXCD = 8, WGM = 8;
__device__ __forceinline__ int lds_byte(int r, int c) { const int st = (r >> 4) * 2 + (c >> 5), rr = r & 15, cc = c & 31, ob = rr * 64 + cc * 2; return st * 1024 + (ob ^ (((ob >> 9) & 1) << 5)); }
__device__ __forceinline__ void stage_rc(int b, int& R, int& C) { const int st = b / 1024, sb = b % 1024, swz = sb ^ (((sb >> 9) & 1) << 5); R = (st >> 1) * 16 + swz / 64; C = (st & 1) * 32 + (swz % 64) / 2; }
__device__ __forceinline__ int perm32(int rho) { const int n = rho >> 4, i = rho & 15; return 8 * (i >> 2) + 4 * n + (i & 3); }
struct Unit { int pm, pn; };
struct Gemm { const bf16_t* A; const bf16_t* Bt; int M, N, K; };
struct StaticOrder {
    int nM, nN, nwg, G, c;
    __device__ void init(int M, int N, int G_, int c_) { nM = M / BM; nN = N / BM; nwg = nM * nN; G = G_; c = c_; }
    __device__ bool next(int i, Unit& u) const {
        const long L = (long)i * G + c; if (L >= nwg) return false;
        int wgid = (int)L; { const int q = nwg / NXCD, r = nwg % NXCD, xcd = wgid % NXCD, off = wgid / NXCD; wgid = (xcd < r ? xcd * (q + 1) : r * (q + 1) + (xcd - r) * q) + off; }
        const int nig = WGM * nN, gid = wgid / nig, fm = gid * WGM, gsz = (nM - fm) < WGM ? (nM - fm) : WGM;
        u.pm = fm + ((wgid % nig) % gsz); u.pn = (wgid % nig) / gsz; return true;
    }
};
struct EpiR {
    static constexpr bool PERM = true;
    bf16_t* O; int ldc; int row_base; int mode; const float* cs; const float* sn;
    __device__ __forceinline__ void operator()(const f32x4 (&acc)[2][2][4][2], const Unit& u, int wr, int wc, int fr, int fq) const {
        const int row0 = u.pm * BM + wr * 64 + fr, col0 = u.pn * BM + wc * 32 + 8 * fq;
        const bool rope = (mode == 2) && ((row_base + u.pm * BM) >= TC) && (u.pn < 8);
        const int j0 = 16 * (wc & 1) + 4 * fq;
#pragma unroll
        for (int ai = 0; ai < 2; ++ai)
#pragma unroll
            for (int m = 0; m < 4; ++m) { const int r = row0 + ai * HALF + m * 16; bf16_t* rowp = O + (size_t)r * ldc + col0;
                f32x4 c4 = (f32x4){1.f, 1.f, 1.f, 1.f}, s4 = (f32x4){0.f, 0.f, 0.f, 0.f};
                if (rope) { const int t = (row_base + r - TC) & (SEQ - 1); c4 = *(const f32x4*)(cs + t * 32 + j0); s4 = *(const f32x4*)(sn + t * 32 + j0); }
#pragma unroll
                for (int bj = 0; bj < 2; ++bj) { f32x4 v0 = acc[ai][bj][m][0], v1 = acc[ai][bj][m][1];
                    if (mode == 1) {
#pragma unroll
                        for (int j = 0; j < 4; ++j) { const float a = fmaxf(v0[j], 0.f), b = fmaxf(v1[j], 0.f); v0[j] = a * a; v1[j] = b * b; } }
                    if (rope) { float x1, x2;
                        x1 = v0[0]; x2 = v0[1]; v0[0] = x1 * c4[0] - x2 * s4[0]; v0[1] = x2 * c4[0] + x1 * s4[0];
                        x1 = v0[2]; x2 = v0[3]; v0[2] = x1 * c4[1] - x2 * s4[1]; v0[3] = x2 * c4[1] + x1 * s4[1];
                        x1 = v1[0]; x2 = v1[1]; v1[0] = x1 * c4[2] - x2 * s4[2]; v1[1] = x2 * c4[2] + x1 * s4[2];
                        x1 = v1[2]; x2 = v1[3]; v1[2] = x1 * c4[3] - x2 * s4[3]; v1[3] = x2 * c4[3] + x1 * s4[3]; }
                    u32x4 w; w.x = cvt_pk_bf16(v0[0], v0[1]); w.y = cvt_pk_bf16(v0[2], v0[3]); w.z = cvt_pk_bf16(v1[0], v1[1]); w.w = cvt_pk_bf16(v1[2], v1[3]);
                    *(u32x4*)(rowp + bj * HALF) = w; } }
    }
};

template <class Epi>
__device__ __forceinline__ void gemm_phase(LAS unsigned char* lds, const int tid, const Gemm g, const StaticOrder& S, const Epi& E) {
    const int wid = __builtin_amdgcn_readfirstlane(tid >> 6), lane = tid & 63, wr = wid >> 2, wc = wid & 3, fr = lane & 15, fq = lane >> 4;
    const int K = g.K, nt = K / BK;
    unsigned voffA[2], voffB[2];
#pragma unroll
    for (int i = 0; i < 2; ++i) { int R, C; stage_rc(tid * 16 + i * 8192, R, C); const int Rb = Epi::PERM ? ((R & ~31) + perm32(R & 31)) : R;
        voffA[i] = (unsigned)(R * K + C) * 2u; voffB[i] = (unsigned)(Rb * K + C) * 2u; }
    const size_t kstep = (size_t)(BK * 2);
    const size_t hstep = (size_t)HALF * K * 2;
    const size_t tstep = 2 * hstep;
    const unsigned ldsw = (unsigned)wid * 1024u;
    const int aoff = lds_byte(wr * 64 + fr, fq * 8), boff = lds_byte(wc * 32 + fr, fq * 8);
#define PG8_SA(b, h) (((b) * 2 + (h)) * HTB)
#define PG8_SB(b, h) ((4 + (b) * 2 + (h)) * HTB)
#define PG8_STAGE(bufoff, gbase, voff) do { _Pragma("unroll") for (int _i = 0; _i < 2; ++_i) \
        __builtin_amdgcn_global_load_lds((const unsigned*)((const char*)(gbase) + (voff)[_i]), (LAS unsigned*)(lds + (bufoff) + ldsw + _i * 8192), 16, 0, 0); } while (0)
#define PG8_LDA(dst, b, h) do { _Pragma("unroll") for (int m = 0; m < 4; ++m) _Pragma("unroll") for (int k = 0; k < 2; ++k) dst[m][k] = *(const LAS bf16x8*)(lds + PG8_SA(b, h) + aoff + m * 2048 + k * 1024); } while (0)
#define PG8_LDB(dst, b, h) do { _Pragma("unroll") for (int n = 0; n < 2; ++n) _Pragma("unroll") for (int k = 0; k < 2; ++k) dst[n][k] = *(const LAS bf16x8*)(lds + PG8_SB(b, h) + boff + n * 2048 + k * 1024); } while (0)
#define PG8_MMA(ai, bj, At, Bt) do { __builtin_amdgcn_s_setprio(1); _Pragma("unroll") for (int m = 0; m < 4; ++m) _Pragma("unroll") for (int n = 0; n < 2; ++n) _Pragma("unroll") for (int k = 0; k < 2; ++k) \
        acc[ai][bj][m][n] = __builtin_amdgcn_mfma_f32_16x16x32_bf16(Bt[n][k], At[m][k], acc[ai][bj][m][n], 0, 0, 0); __builtin_amdgcn_s_setprio(0); } while (0)
#define PG8_WAIT_V(n) asm volatile("s_waitcnt vmcnt(" #n ")" ::: "memory")
#define PG8_WAIT_L(n) asm volatile("s_waitcnt lgkmcnt(" #n ")" ::: "memory")
#define PG8_BAR __builtin_amdgcn_s_barrier()
#define PG8_SCHED __builtin_amdgcn_sched_barrier(0)
    Unit cur, nxt; int ui = 0;
    if (!S.next(0, cur)) return;
    f32x4 acc[2][2][4][2];
#pragma unroll
    for (int a = 0; a < 2; ++a)
#pragma unroll
        for (int b = 0; b < 2; ++b)
#pragma unroll
            for (int m = 0; m < 4; ++m)
#pragma unroll
                for (int n = 0; n < 2; ++n) acc[a][b][m][n] = (f32x4){0.f, 0.f, 0.f, 0.f};
    bf16x8 At[4][2], B0[2][2], B1[2][2];
    const char* cA = (const char*)g.A + (size_t)cur.pm * tstep; const char* cB = (const char*)g.Bt + (size_t)cur.pn * tstep;
    PG8_STAGE(PG8_SB(0, 0), cB, voffB); PG8_STAGE(PG8_SA(0, 0), cA, voffA); PG8_STAGE(PG8_SB(0, 1), cB + hstep, voffB); PG8_STAGE(PG8_SA(0, 1), cA + hstep, voffA);
    if (wr == 1) PG8_BAR;
    PG8_WAIT_V(4); PG8_BAR;
    PG8_STAGE(PG8_SB(1, 0), cB + kstep, voffB); PG8_STAGE(PG8_SA(1, 0), cA + kstep, voffA); PG8_STAGE(PG8_SB(1, 1), cB + hstep + kstep, voffB);
    PG8_WAIT_V(6); PG8_BAR;
    for (;;) {
        const bool has_next = S.next(ui + 1, nxt);
        const char* nA = has_next ? (const char*)g.A + (size_t)nxt.pm * tstep : cA; const char* nB = has_next ? (const char*)g.Bt + (size_t)nxt.pn * tstep : cB;
        for (int t = 0; t < nt; t += 2) {
            const bool last = (t == nt - 2);
            const char* a1 = cA + (size_t)(t + 1) * kstep;
            const char* a2 = last ? nA : cA + (size_t)(t + 2) * kstep; const char* b2 = last ? nB : cB + (size_t)(t + 2) * kstep;
            const char* a3 = a2 + kstep; const char* b3 = b2 + kstep;
            PG8_LDB(B0, 0, 0); PG8_SCHED; PG8_LDA(At, 0, 0); PG8_STAGE(PG8_SA(1, 1), a1 + hstep, voffA);
            PG8_WAIT_L(8); PG8_BAR; PG8_WAIT_L(0); PG8_MMA(0, 0, At, B0); PG8_BAR; PG8_SCHED;
            PG8_LDB(B1, 0, 1); PG8_STAGE(PG8_SB(0, 0), b2, voffB);
            PG8_BAR; PG8_WAIT_L(0); PG8_MMA(0, 1, At, B1); PG8_BAR;
            PG8_LDA(At, 0, 1); PG8_STAGE(PG8_SA(0, 0), a2, voffA);
            PG8_BAR; PG8_WAIT_L(0); PG8_MMA(1, 0, At, B0); PG8_BAR; PG8_SCHED;
            PG8_STAGE(PG8_SB(0, 1), b2 + hstep, voffB);
            PG8_WAIT_V(6); PG8_BAR; PG8_MMA(1, 1, At, B1); PG8_BAR;
            PG8_LDB(B0, 1, 0); PG8_SCHED; PG8_LDA(At, 1, 0); PG8_STAGE(PG8_SA(0, 1), a2 + hstep, voffA);
            PG8_WAIT_L(8); PG8_BAR; PG8_WAIT_L(0); PG8_MMA(0, 0, At, B0); PG8_BAR; PG8_SCHED;
            PG8_LDB(B1, 1, 1); PG8_STAGE(PG8_SB(1, 0), b3, voffB);
            PG8_BAR; PG8_WAIT_L(0); PG8_MMA(0, 1, At, B1); PG8_BAR;
            PG8_LDA(At, 1, 1); PG8_STAGE(PG8_SA(1, 0), a3, voffA);
            PG8_BAR; PG8_WAIT_L(0); PG8_MMA(1, 0, At, B0); PG8_BAR; PG8_SCHED;
            PG8_STAGE(PG8_SB(1, 1), b3 + hstep, voffB);
            PG8_WAIT_V(6); PG8_BAR; PG8_MMA(1, 1, At, B1); PG8_BAR;
        }
        E(acc, cur, wr, wc, fr, fq);
        if (!has_next) break;
#pragma unroll
        for (int a = 0; a < 2; ++a)
#pragma unroll
            for (int b = 0; b < 2; ++b)
#pragma unroll
                for (int m = 0; m < 4; ++m)
#pragma unroll
                    for (int n = 0; n < 2; ++n) acc[a][b][m][n] = (f32x4){0.f, 0.f, 0.f, 0.f};
        cur = nxt; cA = nA; cB = nB; ++ui;
    }
    PG8_WAIT_V(0);
    if (wr == 0) PG8_BAR;
    PG8_BAR;
#undef PG8_SA
#undef PG8_SB
#undef PG8_STAGE
#undef PG8_LDA
#undef PG8_LDB
#undef PG8_MMA
#undef PG8_WAIT_V
#undef PG8_WAIT_L
#undef PG8_BAR
#undef PG8_SCHED
}
}

namespace att {
#define SBAR() __builtin_amdgcn_sched_barrier(0)
__device__ __forceinline__ int crow(int r, int hi) { return (r & 3) + 8 * (r >> 2) + 4 * hi; }
__device__ __forceinline__ void partialSM(f32x16& p0, f32x16& p1, float& m_reg, float& mn, float& alpha, const float C, const float THRS) {
    float pmax = p0[0];
#pragma unroll
    for (int r = 1; r < 16; ++r) pmax = fmaxf(pmax, p0[r]);
#pragma unroll
    for (int r = 0; r < 16; ++r) pmax = fmaxf(pmax, p1[r]);
    { auto rr = __builtin_amdgcn_permlane32_swap(__float_as_uint(pmax), __float_as_uint(pmax), false, false);
      pmax = fmaxf(__uint_as_float(rr[0]), __uint_as_float(rr[1])); }
    if (__builtin_expect(__all(pmax - m_reg <= THRS), 1)) { mn = m_reg; alpha = 1.f; }
    else { mn = fmaxf(m_reg, pmax); alpha = __builtin_amdgcn_exp2f((m_reg - mn) * C); m_reg = mn; }
    const float mnC = -mn * C;
#pragma unroll
    for (int r = 0; r < 16; ++r) p0[r] = fmaf(p0[r], C, mnC);
#pragma unroll
    for (int r = 0; r < 16; ++r) p1[r] = fmaf(p1[r], C, mnC);
#pragma unroll
    for (int r = 0; r < 16; ++r) p0[r] = __builtin_amdgcn_exp2f(p0[r]);
}
__device__ __forceinline__ void finishSM(f32x16& p0, f32x16& p1, float alpha, float& l_reg, bf16x8& pa0, bf16x8& pa1, bf16x8& pa2, bf16x8& pa3) {
#pragma unroll
    for (int r = 0; r < 16; ++r) p1[r] = __builtin_amdgcn_exp2f(p1[r]);
    float ps = 0;
#pragma unroll
    for (int r = 0; r < 16; ++r) ps += p0[r];
#pragma unroll
    for (int r = 0; r < 16; ++r) ps += p1[r];
    { auto rr = __builtin_amdgcn_permlane32_swap(__float_as_uint(ps), __float_as_uint(ps), false, false);
      ps = __uint_as_float(rr[0]) + __uint_as_float(rr[1]); }
    l_reg = l_reg * alpha + ps;
#define PK4(P, BASE, OUT) do { unsigned a0 = cvt_pk_bf16(P[BASE + 0], P[BASE + 1]), a1 = cvt_pk_bf16(P[BASE + 2], P[BASE + 3]);   \
    unsigned b0 = cvt_pk_bf16(P[BASE + 4], P[BASE + 5]), b1 = cvt_pk_bf16(P[BASE + 6], P[BASE + 7]);                              \
    auto r0 = __builtin_amdgcn_permlane32_swap(a0, b0, false, false); auto r1 = __builtin_amdgcn_permlane32_swap(a1, b1, false, false); \
    u32x4 w = {r0[0], r1[0], r0[1], r1[1]}; OUT = *reinterpret_cast<bf16x8*>(&w); } while (0)
    PK4(p0, 0, pa0); PK4(p0, 8, pa1); PK4(p1, 0, pa2); PK4(p1, 8, pa3);
#undef PK4
}
template <int ND0, int KSTR>
__device__ __forceinline__ void qkt(f32x16& p0, f32x16& p1, const LAS unsigned char* Ks, const bf16x8* qr, int r32, int hi) {
    p0 = f32x16{}; p1 = f32x16{};
#pragma unroll
    for (int d0 = 0; d0 < ND0; ++d0) { const int cb = (d0 * 16 + hi * 8) * 2;
        const bf16x8 b0 = *(const LAS bf16x8*)(Ks + r32 * KSTR + cb);
        const bf16x8 b1 = *(const LAS bf16x8*)(Ks + (32 + r32) * KSTR + cb);
        p0 = __builtin_amdgcn_mfma_f32_32x32x16_bf16(b0, qr[d0], p0, 0, 0, 0);
        p1 = __builtin_amdgcn_mfma_f32_32x32x16_bf16(b1, qr[d0], p1, 0, 0, 0); }
}
template <int NCB> __device__ __forceinline__ int v_st(int k, int c) { const int kk = (k & ~0xC) | ((k & 4) << 1) | ((k & 8) >> 1); return ((kk >> 3) * NCB + (c >> 5)) * 512 + ((kk & 7) * 32 + (c & 31)) * 2; }
__device__ __forceinline__ int v_rd_base(int lane) { return ((lane & 3) << 3) | (((lane >> 2) & 3) << 6) | (((lane >> 4) & 1) << 5) | (((lane >> 5) & 1) << 8); }
template <int OFF> __device__ __forceinline__ s16x4 tr_read(int vb) {
    s16x4 r; asm volatile("ds_read_b64_tr_b16 %0, %1 offset:%2" : "=&v"(r) : "v"(vb), "i"(OFF) : "memory"); return r;
}
template <int D0, int NCB> __device__ __forceinline__ void pv_one(f32x16& od, int vb, bf16x8 pa0, bf16x8 pa1, bf16x8 pa2, bf16x8 pa3) {
    constexpr int B = D0 * 512, KS = NCB * 1024, HF = NCB * 512;
    const s16x4 l0 = tr_read<B + 0 * KS>(vb), h0 = tr_read<B + 0 * KS + HF>(vb), l1 = tr_read<B + 1 * KS>(vb), h1 = tr_read<B + 1 * KS + HF>(vb);
    const s16x4 l2 = tr_read<B + 2 * KS>(vb), h2 = tr_read<B + 2 * KS + HF>(vb), l3 = tr_read<B + 3 * KS>(vb), h3 = tr_read<B + 3 * KS + HF>(vb);
    asm volatile("s_waitcnt lgkmcnt(0)" ::: "memory"); SBAR();
#define PK(L, H) (bf16x8){L[0], L[1], L[2], L[3], H[0], H[1], H[2], H[3]}
    od = __builtin_amdgcn_mfma_f32_32x32x16_bf16(pa0, PK(l0, h0), od, 0, 0, 0);
    od = __builtin_amdgcn_mfma_f32_32x32x16_bf16(pa1, PK(l1, h1), od, 0, 0, 0);
    od = __builtin_amdgcn_mfma_f32_32x32x16_bf16(pa2, PK(l2, h2), od, 0, 0, 0);
    od = __builtin_amdgcn_mfma_f32_32x32x16_bf16(pa3, PK(l3, h3), od, 0, 0, 0);
#undef PK
}
template <int NCB> __device__ __forceinline__ void pv_all(f32x16* o, int vb, bf16x8 pa0, bf16x8 pa1, bf16x8 pa2, bf16x8 pa3) {
    pv_one<0, NCB>(o[0], vb, pa0, pa1, pa2, pa3); pv_one<1, NCB>(o[1], vb, pa0, pa1, pa2, pa3);
    if constexpr (NCB == 4) { pv_one<2, NCB>(o[2], vb, pa0, pa1, pa2, pa3); pv_one<3, NCB>(o[3], vb, pa0, pa1, pa2, pa3); }
}

template <int DQK, int DV, bool ISDA>
__device__ __forceinline__ void attn_unit(LAS unsigned char* lds, const int tid, const bf16_t* Qp, const int ldq, const bf16_t* K1p, const int ldk1, const bf16_t* K2p, const int ldk2,
                                          const bf16_t* Vp, const int ldv, const int b, const int NT, const float C, const float THRS,
                                          float* scr, bf16_t* Op, const int ldo, const float lam, const float* subg, const float oscale, const float* rcs, const float* rsn, const int tpos0) {
    constexpr int NCB = DV / 32, ND0 = DQK / 16, KSTR = DQK * 2 + 16, SHM_V = 64 * DV * 2, SHM_K = 64 * KSTR;
    const int wid = tid >> 6, lane = tid & 63, r32 = lane & 31, hi = lane >> 5;
    LAS unsigned char* V_lds = lds; LAS unsigned char* K_lds = lds + 2 * SHM_V;
    LAS float* wsf = (LAS float*)(lds + 2 * SHM_V + 2 * SHM_K) + wid * 64; LAS float* li_l = wsf; LAS float* al_l = wsf + 32;
    const int k1r = tid >> 3, k1c = (tid & 7) * 8;
    const int k2r = (tid & 255) >> 2, k2c = (tid & 3) * 8;
    const int vr = tid >> 4, vc = (tid & 15) * 8;
    const int vst0 = ISDA ? v_st<NCB>(vr, vc) : v_st<NCB>(k1r, k1c), vst1 = ISDA ? v_st<NCB>(32 + vr, vc) : 0;
    const int vb0 = (int)(unsigned)(size_t)V_lds + v_rd_base(lane);
    struct { bf16x8 a, b, c; } sr_[2];
#define ROWB(jt) (((jt) < 4) ? (b * CTX + (jt) * 64) : (TC + b * SEQ + ((jt) - 4) * 64))
#define SLOAD(i, jt) do { const int rb_ = ROWB(jt); sr_[i].a = *(const bf16x8*)(K1 + (size_t)(rb_ + k1r) * ldk1 + k1c); \
    if (ISDA) { sr_[i].b = *(const bf16x8*)(Vp + (size_t)(rb_ + vr) * ldv + vc); sr_[i].c = *(const bf16x8*)(Vp + (size_t)(rb_ + 32 + vr) * ldv + vc); } \
    else { sr_[i].b = *(const bf16x8*)(Vp + (size_t)(rb_ + k1r) * ldv + k1c); sr_[i].c = *(const bf16x8*)(K2p + (size_t)(rb_ + k2r) * ldk2 + k2c); } } while (0)
#define SWRITE(bf, i) do { *(LAS bf16x8*)(K_lds + (bf) * SHM_K + k1r * KSTR + k1c * 2) = sr_[i].a; *(LAS bf16x8*)(V_lds + (bf) * SHM_V + vst0) = sr_[i].b; \
    if (ISDA) { *(LAS bf16x8*)(V_lds + (bf) * SHM_V + vst1) = sr_[i].c; } \
    else { if (tid < 256) *(LAS bf16x8*)(K_lds + (bf) * SHM_K + k2r * KSTR + 128 + k2c * 2) = sr_[i].c; } } while (0)
#define SWAIT() asm volatile("s_waitcnt vmcnt(3)" ::: "memory")
#define RESC(a) do { if (__any((a) < 1.f)) { if (hi == 0) al_l[r32] = (a); asm volatile("s_waitcnt lgkmcnt(0)" ::: "memory"); \
    _Pragma("unroll") for (int d = 0; d < NCB; ++d) _Pragma("unroll") for (int r = 0; r < 16; ++r) o[d][r] *= al_l[crow(r, hi)]; } } while (0)
#pragma unroll 1
    for (int mp = 0; mp < (ISDA ? 2 : 1); ++mp) {
        const bf16_t* K1 = K1p + mp * 64;
        float m_reg = -1e30f, l_reg = 0.f; f32x16 o[NCB]; bf16x8 qr[ND0];
#pragma unroll
        for (int d = 0; d < NCB; ++d) o[d] = f32x16{};
        const bf16_t* Qw = Qp + mp * 64 + (size_t)(wid * 32 + r32) * ldq + hi * 8;
#pragma unroll
        for (int d0 = 0; d0 < ND0; ++d0) qr[d0] = *(const bf16x8*)(Qw + d0 * 16);
        if (!ISDA && tpos0 >= 0) {
            const int t = (tpos0 + wid * 32 + r32) & (SEQ - 1);
#pragma unroll
            for (int dd = 0; dd < 2; ++dd) { const int j0 = dd * 8 + hi * 4; const f32x4 c4 = *(const f32x4*)(rcs + t * 16 + j0), s4 = *(const f32x4*)(rsn + t * 16 + j0);
                const u32x4 w = *reinterpret_cast<const u32x4*>(&qr[ND0 - 2 + dd]); u32x4 o4;
                { const float x1 = bf_lo(w.x), x2 = bf_hi(w.x); o4.x = cvt_pk_bf16(x1 * c4[0] - x2 * s4[0], x2 * c4[0] + x1 * s4[0]); }
                { const float x1 = bf_lo(w.y), x2 = bf_hi(w.y); o4.y = cvt_pk_bf16(x1 * c4[1] - x2 * s4[1], x2 * c4[1] + x1 * s4[1]); }
                { const float x1 = bf_lo(w.z), x2 = bf_hi(w.z); o4.z = cvt_pk_bf16(x1 * c4[2] - x2 * s4[2], x2 * c4[2] + x1 * s4[2]); }
                { const float x1 = bf_lo(w.w), x2 = bf_hi(w.w); o4.w = cvt_pk_bf16(x1 * c4[3] - x2 * s4[3], x2 * c4[3] + x1 * s4[3]); }
                qr[ND0 - 2 + dd] = *reinterpret_cast<const bf16x8*>(&o4); }
        }
        f32x16 pA0, pA1, pB0, pB1; float mnA, mnB, alA, alB; bf16x8 pa0, pa1, pa2, pa3;
        SLOAD(0, 0); asm volatile("s_waitcnt vmcnt(0)" ::: "memory"); SWRITE(0, 0); __syncthreads();
        qkt<ND0, KSTR>(pA0, pA1, K_lds, qr, r32, hi); partialSM(pA0, pA1, m_reg, mnA, alA, C, THRS);
        SLOAD(1, 1); if (2 < NT) SLOAD(0, 2);
        SWAIT(); SWRITE(1, 1); __syncthreads();
        for (int j = 1; j + 1 < NT; j += 2) {
            SBAR(); qkt<ND0, KSTR>(pB0, pB1, K_lds + SHM_K, qr, r32, hi);
            finishSM(pA0, pA1, alA, l_reg, pa0, pa1, pa2, pa3); SBAR();
            SLOAD(1, j + 2); SBAR();
            pv_all<NCB>(o, vb0, pa0, pa1, pa2, pa3); partialSM(pB0, pB1, m_reg, mnB, alB, C, THRS);
            __syncthreads(); SWAIT(); SWRITE(0, 0);
            RESC(alB); __syncthreads();
            SBAR(); qkt<ND0, KSTR>(pA0, pA1, K_lds, qr, r32, hi);
            finishSM(pB0, pB1, alB, l_reg, pa0, pa1, pa2, pa3); SBAR();
            if (j + 3 < NT) SLOAD(0, j + 3); SBAR();
            pv_all<NCB>(o, vb0 + SHM_V, pa0, pa1, pa2, pa3); partialSM(pA0, pA1, m_reg, mnA, alA, C, THRS);
            __syncthreads(); SWAIT(); SWRITE(1, 1);
            RESC(alA); __syncthreads();
        }
        SBAR(); qkt<ND0, KSTR>(pB0, pB1, K_lds + SHM_K, qr, r32, hi);
        finishSM(pA0, pA1, alA, l_reg, pa0, pa1, pa2, pa3); SBAR();
        pv_all<NCB>(o, vb0, pa0, pa1, pa2, pa3); partialSM(pB0, pB1, m_reg, mnB, alB, C, THRS);
        __syncthreads(); RESC(alB);
        finishSM(pB0, pB1, alB, l_reg, pa0, pa1, pa2, pa3); SBAR();
        pv_all<NCB>(o, vb0 + SHM_V, pa0, pa1, pa2, pa3);
        int r32e = r32, hie = hi, wide = wid; asm volatile("" : "+v"(r32e), "+v"(hie), "+v"(wide));
        if (hi == 0) li_l[r32] = l_reg; asm volatile("s_waitcnt lgkmcnt(0)" ::: "memory");
        float rli[16];
#pragma unroll
        for (int r = 0; r < 16; ++r) rli[r] = __builtin_amdgcn_rcpf(li_l[crow(r, hie)]);
        if (ISDA && mp == 0) {
#pragma unroll
            for (int r = 0; r < 16; ++r) { const int orow = wide * 32 + crow(r, hie);
#pragma unroll
                for (int d0 = 0; d0 < NCB; ++d0) scr[orow * DV + d0 * 32 + r32e] = o[d0][r] * rli[r]; }
        } else if (ISDA) {
            float sg[NCB];
#pragma unroll
            for (int d0 = 0; d0 < NCB; ++d0) sg[d0] = subg[d0 * 32 + r32e] * oscale;
#pragma unroll
            for (int r = 0; r < 16; ++r) { const int orow = wide * 32 + crow(r, hie); float ss = 0.f;
#pragma unroll
                for (int d0 = 0; d0 < NCB; ++d0) { const float x = scr[orow * DV + d0 * 32 + r32e] - lam * (o[d0][r] * rli[r]); o[d0][r] = x; ss += x * x; }
#pragma unroll
                for (int off = 1; off < 32; off <<= 1) ss += __shfl_xor(ss, off);
                const float rstd = rsqrtf(ss * (1.0f / DV) + EPS);
#pragma unroll
                for (int d0 = 0; d0 < NCB; ++d0) Op[(size_t)orow * ldo + d0 * 32 + r32e] = (bf16_t)(cvt_pk_bf16(o[d0][r] * rstd * sg[d0], 0.f) & 0xffffu); }
        } else {
#pragma unroll
            for (int r = 0; r < 16; ++r) { const int orow = wide * 32 + crow(r, hie);
#pragma unroll
                for (int d0 = 0; d0 < NCB; ++d0) Op[(size_t)orow * ldo + d0 * 32 + r32e] = (bf16_t)(cvt_pk_bf16(o[d0][r] * rli[r], 0.f) & 0xffffu); }
        }
        __syncthreads();
    }
#undef ROWB
#undef SLOAD
#undef SWRITE
#undef SWAIT
#undef RESC
}
}

__device__ const int JOBS[18][10] = {
    {7, 0 * 1024 * 4096, (int)(W_MLP_IN + 0 * 8 * MiB), 1024, 4096, 1024, 0, 4096, 0, 0},
    {7, 1 * 1024 * 4096, (int)(W_MLP_IN + 1 * 8 * MiB), 1024, 4096, 1024, 0, 4096, 0, 0},
    {7, 2 * 1024 * 4096, (int)(W_MLP_IN + 2 * 8 * MiB), 1024, 4096, 1024, 0, 4096, 0, 0},
    {7, 3 * 1024 * 4096, (int)(W_MLP_IN + 3 * 8 * MiB), 1024, 4096, 1024, 0, 4096, 0, 0},
    {8, 0 * 1024 * 4096, (int)(W_MLP_OUT + 0 * 8 * MiB), 4096, 1024, 4096, 0, 1024, 0, 0},
    {8, 1 * 1024 * 4096, (int)(W_MLP_OUT + 1 * 8 * MiB), 4096, 1024, 4096, 0, 1024, 0, 0},
    {8, 2 * 1024 * 4096, (int)(W_MLP_OUT + 2 * 8 * MiB), 4096, 1024, 4096, 0, 1024, 0, 0},
    {8, 3 * 1024 * 4096, (int)(W_MLP_OUT + 3 * 8 * MiB), 4096, 1024, 4096, 0, 1024, 0, 0},
    {9, 0 * 1024 * 3072, (int)(W_DA_QKV + 0 * 6 * MiB), 1024, 3072, 1024, 0, 3072, 0, 1},
    {9, 1 * 1024 * 3072, (int)(W_DA_QKV + 1 * 6 * MiB), 1024, 3072, 1024, 0, 3072, 0, 1},
    {12, 0 * 1024 * 1024, (int)(W_DA_OUT + 0 * 2 * MiB), 1024, 1024, 1024, 0, 1024, 0, 0},
    {12, 1 * 1024 * 1024, (int)(W_DA_OUT + 1 * 2 * MiB), 1024, 1024, 1024, 0, 1024, 0, 0},
    {13, 0, (int)W_MLA_DOWN, 1024, 416, 1024, 0, 512, 0, 3},
    {15, 0, (int)W_MLA_UP, 256, 1536, 384, 0, 1536, 0, 2},
    {17, 0, (int)W_MLA_UP, 128, 2048, 384, 256, 2048, 1536, 0},
    {18, 0, (int)W_MLA_OUT, 1024, 1024, 1024, 0, 1024, 0, 0},
    {19, 0, (int)W_SC_IN, 1024, 3072, 1024, 0, 3072, 0, 0},
    {21, 0, (int)W_SC_OUT, 1024, 1024, 1024, 0, 1024, 0, 0},
};
constexpr int NTILES = 11984, NMODT = 768;
__device__ __forceinline__ int smap(int mode, int n) {
    if (mode == 1) { if (n < 2048) { const int p = n & 63; return (n - p) + ((p & 1) ? 32 + (p >> 1) : (p >> 1)); } return n; }
    if (mode == 2) { const int hc = n % 96; if (hc >= 64) { const int p = hc - 64; return n - p + ((p & 1) ? 16 + (p >> 1) : (p >> 1)); } return n; }
    if (mode == 3) { if (n >= 384 && n < 416) { const int p = n - 384; return 384 + ((p & 1) ? 16 + (p >> 1) : (p >> 1)); } return n; }
    return n;
}
__device__ __forceinline__ const float* in_ptr(const Params& p, int idx) {
    const float* r = p.in[7];
    if (idx == 8) r = p.in[8]; if (idx == 9) r = p.in[9]; if (idx == 12) r = p.in[12]; if (idx == 13) r = p.in[13]; if (idx == 15) r = p.in[15];
    if (idx == 17) r = p.in[17]; if (idx == 18) r = p.in[18]; if (idx == 19) r = p.in[19]; if (idx == 21) r = p.in[21];
    return r;
}
__device__ __forceinline__ void prep_phase(const Params& p, LAS unsigned char* lds, const int tid, const int bid, const int G) {
    const int wid = tid >> 6, lane = tid & 63;
    LAS float* st = (LAS float*)lds;
    LAS float* red = (LAS float*)(lds + 81920);
    { float* csda = (float*)(p.ws + WS_TAB + TAB_CSDA); float* snda = (float*)(p.ws + WS_TAB + TAB_SNDA);
      float* csm = (float*)(p.ws + WS_TAB + TAB_CSMLA); float* snm = (float*)(p.ws + WS_TAB + TAB_SNMLA);
      const float L2T = 13.287712379549449f;
      for (int i = bid * 512 + tid; i < 65536 + 32768; i += G * 512) {
          if (i < 65536) { const int t = i >> 5, j = i & 31; const float pos = (j < 16) ? (float)(t >> 6) : (float)(t & 63);
              const float invf = exp2f(-(float)(j & 15) * (1.0f / 16.0f) * L2T); const float ang = pos * invf; csda[i] = __cosf(ang); snda[i] = __sinf(ang); }
          else { const int ii = i - 65536, t = ii >> 4, j = ii & 15; const float pos = (j < 8) ? (float)(t >> 6) : (float)(t & 63);
              const float invf = exp2f(-(float)(j & 7) * (1.0f / 8.0f) * L2T); const float ang = pos * invf; csm[ii] = __cosf(ang); snm[ii] = __sinf(ang); } } }
    for (int i = tid; i < 1024 * 20; i += 512) { const int k = i / 20, r = i % 20; float v = 0.f;
        if (r < 16) v = p.in[1][r * 1024 + k]; else if (r == 16) v = p.in[3][k];
        st[i] = (r <= 16) ? v / (1.0f + __expf(-v)) : 0.f; }
    __syncthreads();
    float* mod = (float*)(p.ws + WS_MOD);
    for (int task = bid; task < NMODT + NTILES; task += G) {
        if (task < NMODT) {
            const int n0 = task * 32, layer = n0 / 6144, col0 = n0 % 6144, hf = lane >> 5, cl = lane & 31, part = wid * 2 + hf;
            const float* W = p.in[4] + (size_t)layer * 1024 * 6144 + col0 + cl;
            float acc[17];
#pragma unroll
            for (int r = 0; r < 17; ++r) acc[r] = 0.f;
#pragma unroll 4
            for (int kk = 0; kk < 64; ++kk) { const int k = part * 64 + kk; const float wv = W[(size_t)k * 6144];
                const LAS f32x4* s4 = (const LAS f32x4*)(st + k * 20);
                const f32x4 s0 = s4[0], s1 = s4[1], s2 = s4[2], s3 = s4[3], s5 = s4[4];
                acc[0] += s0[0] * wv; acc[1] += s0[1] * wv; acc[2] += s0[2] * wv; acc[3] += s0[3] * wv;
                acc[4] += s1[0] * wv; acc[5] += s1[1] * wv; acc[6] += s1[2] * wv; acc[7] += s1[3] * wv;
                acc[8] += s2[0] * wv; acc[9] += s2[1] * wv; acc[10] += s2[2] * wv; acc[11] += s2[3] * wv;
                acc[12] += s3[0] * wv; acc[13] += s3[1] * wv; acc[14] += s3[2] * wv; acc[15] += s3[3] * wv;
                acc[16] += s5[0] * wv; }
#pragma unroll
            for (int r = 0; r < 17; ++r) red[(part * 17 + r) * 32 + cl] = acc[r];
            __syncthreads();
            for (int i = tid; i < 17 * 32; i += 512) { const int r = i >> 5, c = i & 31; float s = p.in[5][layer * 6144 + col0 + c];
#pragma unroll
                for (int q = 0; q < 16; ++q) s += red[(q * 17 + r) * 32 + c];
                mod[(size_t)(layer * 17 + r) * 6144 + col0 + c] = s; }
            __syncthreads();
        } else {
            int tt = task - NMODT, job = 0;
            for (; job < 17; ++job) { const int ntl = (JOBS[job][7] >> 6) * (JOBS[job][5] >> 6); if (tt < ntl) break; tt -= ntl; }
            const int in_idx = JOBS[job][0], src_off = JOBS[job][1], dst_off = JOBS[job][2], Ksrc = JOBS[job][3], Nsrc = JOBS[job][4], Kd = JOBS[job][5],
                      koff = JOBS[job][6], noff = JOBS[job][8], mode = JOBS[job][9];
            const int ktiles = Kd >> 6, ntile = tt / ktiles, kt = tt % ktiles, n0 = ntile * 64, k0 = kt * 64;
            const float* src = in_ptr(p, in_idx) + src_off;
            bf16_t* dst = (bf16_t*)(p.ws + dst_off);
            LAS float* tile = red;
            { const int i = tid & 63, kq = tid >> 6; const int sc = smap(mode, n0 + i); const bool cv = sc < Nsrc;
#pragma unroll
              for (int j = 0; j < 8; ++j) { const int k = kq + 8 * j, ks = k0 + k - koff; float v = 0.f;
                  if (cv && ks >= 0 && ks < Ksrc) v = src[(size_t)ks * Nsrc + sc];
                  tile[k * 65 + i] = v; } }
            __syncthreads();
            { const int n = tid >> 3, c = tid & 7; const LAS float* s = tile + (8 * c) * 65 + n;
              u32x4 o; o.x = cvt_pk_bf16(s[0 * 65], s[1 * 65]); o.y = cvt_pk_bf16(s[2 * 65], s[3 * 65]); o.z = cvt_pk_bf16(s[4 * 65], s[5 * 65]); o.w = cvt_pk_bf16(s[6 * 65], s[7 * 65]);
              *(u32x4*)(dst + (size_t)(noff + n0 + n) * Kd + k0 + 8 * c) = o; }
            __syncthreads();
        }
    }
}

__device__ __forceinline__ void row_phase(const Params& p, const int li, const int ykind, const int nl, const int nkind, const bool first, const bool lat_only, const bf16_t* Y, const int tid, const int bid, const int G) {
    const int wid = tid >> 6, lane = tid & 63, gw = bid * 8 + wid, NGW = G * 8;
    const float* mod = (const float*)(p.ws + WS_MOD); const float* ng = p.in[6];
    float* hc = (float*)(p.ws + WS_HC); bf16_t* A = (bf16_t*)(p.ws + WS_A);
    const int gk = (ykind == 1) ? 2 : 5, gi = (ykind == 1) ? 1 : 3;
    const int shk = (nkind == 1) ? 3 : 0, sck = (nkind == 1) ? 4 : 1, gn = (nkind == 1) ? 2 : 0;
    const int ntask = lat_only ? 2048 : 4096;
    for (int task = gw; task < ntask; task += NGW) {
        const bool lat = task < 2048; int r0, nr, mb;
        if (lat) { r0 = TC + task * 16; nr = 16; mb = task >> 7; } else { r0 = (task - 2048) * 2; nr = 2; mb = 16; }
        f32x4 G1[4], G2[4], SH[4];
#pragma unroll
        for (int j = 0; j < 4; ++j) { const int col = 4 * lane + 256 * j;
            G1[j] = (f32x4){0.f, 0.f, 0.f, 0.f}; G2[j] = G1[j]; SH[j] = G1[j];
            if (ykind) G1[j] = *(const f32x4*)(mod + (size_t)(li * 17 + mb) * 6144 + gk * 1024 + col) * *(const f32x4*)(ng + (li * 4 + gi) * 1024 + col);
            if (nkind) { G2[j] = *(const f32x4*)(ng + (nl * 4 + gn) * 1024 + col) * (*(const f32x4*)(mod + (size_t)(nl * 17 + mb) * 6144 + sck * 1024 + col) + 1.0f);
                SH[j] = *(const f32x4*)(mod + (size_t)(nl * 17 + mb) * 6144 + shk * 1024 + col); } }
        for (int r = r0; r < r0 + nr; ++r) {
            const float* hs = first ? (lat ? p.in[0] + (size_t)(r - TC) * DM : p.in[2] + (size_t)r * DM) : (lat ? p.out + (size_t)(r - TC) * DM : hc + (size_t)r * DM);
            float* hd = lat ? p.out + (size_t)(r - TC) * DM : hc + (size_t)r * DM;
            f32x4 hv[4];
#pragma unroll
            for (int j = 0; j < 4; ++j) hv[j] = *(const f32x4*)(hs + 4 * lane + 256 * j);
            if (ykind) {
                f32x4 yv[4]; float ss = 0.f;
#pragma unroll
                for (int j = 0; j < 4; ++j) { const u32x2 w = *(const u32x2*)(Y + (size_t)r * DM + 4 * lane + 256 * j);
                    yv[j] = (f32x4){bf_lo(w.x), bf_hi(w.x), bf_lo(w.y), bf_hi(w.y)}; ss += yv[j][0] * yv[j][0] + yv[j][1] * yv[j][1] + yv[j][2] * yv[j][2] + yv[j][3] * yv[j][3]; }
                const float rstd = rsqrtf(wave_sum(ss) * (1.0f / DM) + EPS);
#pragma unroll
                for (int j = 0; j < 4; ++j) hv[j] += G1[j] * (yv[j] * rstd);
            }
            if (first || ykind) {
#pragma unroll
                for (int j = 0; j < 4; ++j) *(f32x4*)(hd + 4 * lane + 256 * j) = hv[j]; }
            if (nkind) {
                float ss = 0.f;
#pragma unroll
                for (int j = 0; j < 4; ++j) ss += hv[j][0] * hv[j][0] + hv[j][1] * hv[j][1] + hv[j][2] * hv[j][2] + hv[j][3] * hv[j][3];
                const float rstd = rsqrtf(wave_sum(ss) * (1.0f / DM) + EPS);
#pragma unroll
                for (int j = 0; j < 4; ++j) { const f32x4 a = hv[j] * rstd * G2[j] + SH[j];
                    u32x2 w; w.x = cvt_pk_bf16(a[0], a[1]); w.y = cvt_pk_bf16(a[2], a[3]);
                    *(u32x2*)(A + (size_t)r * DM + 4 * lane + 256 * j) = w; }
            }
        }
    }
}

__device__ __forceinline__ void mla_norm_phase(const Params& p, const int tid, const int bid, const int G) {
    const int wid = tid >> 6, lane = tid & 63, gw = bid * 8 + wid, NGW = G * 8;
    const bf16_t* dn = (const bf16_t*)(p.ws + WS_BIG); bf16_t* A2 = (bf16_t*)(p.ws + WS_BIG + BIG_A2); bf16_t* KR = (bf16_t*)(p.ws + WS_BIG + BIG_KR);
    const float* csm = (const float*)(p.ws + WS_TAB + TAB_CSMLA); const float* snm = (const float*)(p.ws + WS_TAB + TAB_SNMLA);
    const f32x4 qg = *(const f32x4*)(p.in[14] + 4 * lane); const f32x4 kg = (lane < 32) ? *(const f32x4*)(p.in[16] + 4 * lane) : (f32x4){0.f, 0.f, 0.f, 0.f};
    for (int r = gw; r < TT; r += NGW) {
        const u32x2 w0_ = *(const u32x2*)(dn + (size_t)r * 512 + 4 * lane), w1_ = *(const u32x2*)(dn + (size_t)r * 512 + 256 + 4 * lane);
        const f32x4 v0 = (f32x4){bf_lo(w0_.x), bf_hi(w0_.x), bf_lo(w0_.y), bf_hi(w0_.y)}, v1 = (f32x4){bf_lo(w1_.x), bf_hi(w1_.x), bf_lo(w1_.y), bf_hi(w1_.y)};
        const float sq = wave_sum(v0[0] * v0[0] + v0[1] * v0[1] + v0[2] * v0[2] + v0[3] * v0[3]);
        const float sk = wave_sum(lane < 32 ? (v1[0] * v1[0] + v1[1] * v1[1] + v1[2] * v1[2] + v1[3] * v1[3]) : 0.f);
        const float rq = rsqrtf(sq * (1.0f / 256.0f) + EPS), rk = rsqrtf(sk * (1.0f / 128.0f) + EPS);
        { const f32x4 a = v0 * rq * qg; u32x2 w; w.x = cvt_pk_bf16(a[0], a[1]); w.y = cvt_pk_bf16(a[2], a[3]); *(u32x2*)(A2 + (size_t)r * 384 + 4 * lane) = w; }
        if (lane < 32) { const f32x4 a = v1 * rk * kg; u32x2 w; w.x = cvt_pk_bf16(a[0], a[1]); w.y = cvt_pk_bf16(a[2], a[3]); *(u32x2*)(A2 + (size_t)r * 384 + 256 + 4 * lane) = w; }
        else if (lane < 40) { f32x4 a = v1; const int j = 2 * (lane - 32);
            if (r >= TC) { const int t = (r - TC) & (SEQ - 1); const float c0 = csm[t * 16 + j], s0 = snm[t * 16 + j], c1 = csm[t * 16 + j + 1], s1 = snm[t * 16 + j + 1];
                a[0] = v1[0] * c0 - v1[1] * s0; a[1] = v1[1] * c0 + v1[0] * s0; a[2] = v1[2] * c1 - v1[3] * s1; a[3] = v1[3] * c1 + v1[2] * s1; }
            u32x2 w; w.x = cvt_pk_bf16(a[0], a[1]); w.y = cvt_pk_bf16(a[2], a[3]); *(u32x2*)(KR + (size_t)r * 32 + 4 * (lane - 32)) = w; }
    }
}

__device__ __forceinline__ void conv_phase(const Params& p, const bool with_ctx, const int tid, const int bid, const int G) {
    const int wid = tid >> 6, lane = tid & 63, gw = bid * 8 + wid, NGW = G * 8;
    const bf16_t* X = (const bf16_t*)(p.ws + WS_BIG); bf16_t* Z = (bf16_t*)(p.ws + WS_A); const float* cw = p.in[20];
    const int ntask = (with_ctx ? TT : TL) / 16 * 2;
    for (int task = gw; task < ntask; task += NGW) {
        const int half = task & 1; int r0 = (task >> 1) * 16; if (!with_ctx) r0 += TC; else { r0 = (r0 < TL) ? r0 + TC : r0 - TL; }
        const int d0 = half * 512 + lane * 8;
        const bool lat = r0 >= TC; const int len = lat ? SEQ : CTX; const int t0 = lat ? ((r0 - TC) & (SEQ - 1)) : (r0 & (CTX - 1));
        float w0[8], w1[8], w2[8];
#pragma unroll
        for (int e = 0; e < 8; ++e) { w0[e] = cw[d0 + e]; w1[e] = cw[1024 + d0 + e]; w2[e] = cw[2048 + d0 + e]; }
        float pv[8], cv[8], nv[8];
#define LOADCH(dst, row) do { const u32x4 c_ = *(const u32x4*)(X + (size_t)(row) * 3072 + 1024 + d0), h_ = *(const u32x4*)(X + (size_t)(row) * 3072 + 2048 + d0); \
        dst[0] = bf_lo(c_.x) * bf_lo(h_.x); dst[1] = bf_hi(c_.x) * bf_hi(h_.x); dst[2] = bf_lo(c_.y) * bf_lo(h_.y); dst[3] = bf_hi(c_.y) * bf_hi(h_.y); \
        dst[4] = bf_lo(c_.z) * bf_lo(h_.z); dst[5] = bf_hi(c_.z) * bf_hi(h_.z); dst[6] = bf_lo(c_.w) * bf_lo(h_.w); dst[7] = bf_hi(c_.w) * bf_hi(h_.w); } while (0)
#pragma unroll
        for (int e = 0; e < 8; ++e) pv[e] = 0.f;
        if (t0 > 0) LOADCH(pv, r0 - 1);
        LOADCH(cv, r0);
        for (int i = 0; i < 16; ++i) {
#pragma unroll
            for (int e = 0; e < 8; ++e) nv[e] = 0.f;
            if (t0 + i + 1 < len) LOADCH(nv, r0 + i + 1);
            const u32x4 b_ = *(const u32x4*)(X + (size_t)(r0 + i) * 3072 + d0);
            float bb[8] = {bf_lo(b_.x), bf_hi(b_.x), bf_lo(b_.y), bf_hi(b_.y), bf_lo(b_.z), bf_hi(b_.z), bf_lo(b_.w), bf_hi(b_.w)};
            float z[8];
#pragma unroll
            for (int e = 0; e < 8; ++e) z[e] = bb[e] * (w0[e] * pv[e] + w1[e] * cv[e] + w2[e] * nv[e]);
            u32x4 o; o.x = cvt_pk_bf16(z[0], z[1]); o.y = cvt_pk_bf16(z[2], z[3]); o.z = cvt_pk_bf16(z[4], z[5]); o.w = cvt_pk_bf16(z[6], z[7]);
            *(u32x4*)(Z + (size_t)(r0 + i) * DM + d0) = o;
#pragma unroll
            for (int e = 0; e < 8; ++e) { pv[e] = cv[e]; cv[e] = nv[e]; }
        }
#undef LOADCH
    }
}

template <bool ISDA>
__device__ __forceinline__ void attn_phase(const Params& p, LAS unsigned char* lds, const int j, const bool ctx_out, const float lambda_init, const int tid, const int bid, const int G) {
    const int lane = tid & 63;
    const int v = (G % 8 == 0) ? (bid % 8) * (G / 8) + bid / 8 : bid;
    constexpr int NH = ISDA ? 8 : 16;
    const int nlat = NB * NH * 8, nctx = ctx_out ? NB * NH : 0;
    bf16_t* AO = (bf16_t*)(p.ws + WS_A);
    float lam = 0.f;
    if (ISDA) { const float* lv = p.in[10] + j * 256; const float a = wave_sum(lv[lane] * lv[64 + lane]), b2 = wave_sum(lv[128 + lane] * lv[192 + lane]); lam = expf(a) - expf(b2) + lambda_init; }
    for (int L = v; L < nlat + nctx; L += G) {
        int b, h, qrow, NT;
        if (L < nlat) { const int bh = L >> 3, qb = L & 7; b = bh / NH; h = bh % NH; qrow = TC + b * SEQ + qb * 256; NT = 36; }
        else { const int Lc = L - nlat; b = Lc / NH; h = Lc % NH; qrow = b * CTX; NT = 4; }
        if (ISDA) {
            const bf16_t* QKV = (const bf16_t*)(p.ws + WS_BIG);
            float* scr = (float*)(p.ws + WS_BIG + BIG_SCR) + (size_t)bid * 256 * 128;
            att::attn_unit<64, 128, true>(lds, tid, QKV + (size_t)qrow * 3072 + h * 128, 3072, QKV + 1024 + h * 128, 3072, nullptr, 0, QKV + 2048 + h * 128, 3072, b, NT,
                                          0.125f * 1.4426950408889634f, 64.0f, scr, AO + (size_t)qrow * DM + h * 128, DM, lam, p.in[11] + j * 128, 1.0f - lambda_init, nullptr, nullptr, -1);
        } else {
            const bf16_t* UP = (const bf16_t*)(p.ws + WS_BIG); const bf16_t* KR = (const bf16_t*)(p.ws + WS_BIG + BIG_KR);
            att::attn_unit<96, 64, false>(lds, tid, UP + (size_t)qrow * 3584 + h * 96, 3584, UP + 1536 + h * 128, 3584, KR, 32, UP + 1536 + h * 128 + 64, 3584, b, NT,
                                          0.10206207261596577f * 1.4426950408889634f, 78.383671769f, nullptr, AO + (size_t)qrow * DM + h * 64, DM, 0.f, nullptr, 1.f, (const float*)(p.ws + WS_TAB + TAB_CSMLA), (const float*)(p.ws + WS_TAB + TAB_SNMLA), (L < nlat) ? (qrow - TC) : -1);
        }
    }
}

constexpr int NPH = 2 + 9 * DEPTH;
__host__ __device__ inline bool phase_active(int ph) {
    if (ph < 2) return true; const int i = (ph - 2) / 9, s = (ph - 2) % 9, kind = i % 3;
    if (s == 1 || s == 2) return kind == 1;
    return true;
}
__global__ void __launch_bounds__(512, 2) mega(Params p) {
    extern __shared__ __attribute__((aligned(16))) unsigned char lds_raw[];
    LAS unsigned char* lds = (LAS unsigned char*)lds_raw;
    for (int ph = p.ph_lo; ph < p.ph_hi; ++ph) {
        if (!phase_active(ph)) continue;
        int tid = threadIdx.x; asm volatile("" : "+v"(tid));
        int bid = blockIdx.x; asm volatile("" : "+s"(bid));
        int G = gridDim.x; asm volatile("" : "+s"(G));
        if (ph == 0) { if (EN_PREP) prep_phase(p, lds, tid, bid, G); }
        else if (ph == 1) { if (EN_ROW) row_phase(p, 0, 0, 0, 2, true, false, nullptr, tid, bid, G); }
        else {
            const int i = (ph - 2) / 9, s = (ph - 2) % 9, kind = i % 3, j = i / 3; const bool last = (i == DEPTH - 1);
            const bf16_t* A = (const bf16_t*)(p.ws + WS_A); bf16_t* BIGB = (bf16_t*)(p.ws + WS_BIG);
            const int rb = last ? TC : 0, Mrows = last ? TL : TT;
            if (s == 0 || s == 2 || s == 4 || s == 6 || s == 7) {
                const bf16_t* Ain = A; const bf16_t* Wt; bf16_t* Oo = BIGB; int M = TT, N, K = DM, mode = 0, rbase = 0;
                if (s == 0) {
                    if (kind == 0) { Wt = (const bf16_t*)(p.ws + W_DA_QKV + (size_t)j * 6 * MiB); N = 3072; mode = 2; }
                    else if (kind == 1) { Wt = (const bf16_t*)(p.ws + W_MLA_DOWN); N = 512; }
                    else { Wt = (const bf16_t*)(p.ws + W_SC_IN); N = 3072; }
                } else if (s == 2) { Ain = (const bf16_t*)(p.ws + WS_BIG + BIG_A2); Wt = (const bf16_t*)(p.ws + W_MLA_UP); N = 3584; K = 384;
                } else if (s == 4) { Wt = (kind == 0) ? (const bf16_t*)(p.ws + W_DA_OUT + (size_t)j * 2 * MiB) : (kind == 1) ? (const bf16_t*)(p.ws + W_MLA_OUT) : (const bf16_t*)(p.ws + W_SC_OUT);
                    N = DM; M = Mrows; rbase = rb;
                } else if (s == 6) { Wt = (const bf16_t*)(p.ws + W_MLP_IN + (size_t)i * 8 * MiB); N = HID; M = Mrows; rbase = rb; mode = 1;
                } else { Ain = BIGB; Wt = (const bf16_t*)(p.ws + W_MLP_OUT + (size_t)i * 8 * MiB); Oo = (bf16_t*)(p.ws + WS_A); N = DM; K = HID; M = Mrows; rbase = rb; }
                pg8::StaticOrder S; pg8::Gemm g{Ain + (size_t)rbase * K, Wt, M, N, K}; S.init(M, N, G, bid);
                pg8::EpiR E{Oo + (size_t)rbase * N, N, rbase, mode, (const float*)(p.ws + WS_TAB + TAB_CSDA), (const float*)(p.ws + WS_TAB + TAB_SNDA)};
                if (EN_GEMM) pg8::gemm_phase(lds, tid, g, S, E);
            } else if (s == 1) { if (EN_MISC) mla_norm_phase(p, tid, bid, G);
            } else if (s == 3) {
                if (kind == 0) { if (EN_DA) attn_phase<true>(p, lds, j, !last, 0.8f - 0.6f * __expf(-0.3f * (float)i), tid, bid, G); }
                else if (kind == 1) { if (EN_MLA) attn_phase<false>(p, lds, j, !last, 0.f, tid, bid, G); }
                else { if (EN_MISC) conv_phase(p, !last, tid, bid, G); }
            } else if (s == 5) { if (EN_ROW) row_phase(p, i, 1, i, 1, false, last, BIGB, tid, bid, G);
            } else { if (EN_ROW) row_phase(p, i, 2, i + 1, last ? 0 : 2, false, last, A, tid, bid, G); }
        }
        if (p.coop && ph + 1 < p.ph_hi) cg::this_grid().sync();
    }
}

extern "C" void kernel_launch(void* const* d_in, const int* in_sizes, int n_in, void* d_out, int out_size, void* d_ws, size_t ws_size, hipStream_t stream) {
    static int grid = 0;
    if (grid == 0) {
        if (n_in != 22 || out_size != TL * DM || ws_size < WS_END) { fprintf(stderr, "kernel_launch: unexpected shapes: n_in %d out %d ws %zu (need %zu)\n", n_in, out_size, ws_size, (size_t)WS_END); grid = -1; return; }
        int dev = 0, cus = 0, per_cu = 0;
        hipGetDevice(&dev); hipDeviceGetAttribute(&cus, hipDeviceAttributeMultiprocessorCount, dev);
        if (hipFuncSetAttribute((const void*)mega, hipFuncAttributeMaxDynamicSharedMemorySize, LDS_BYTES) != hipSuccess) { fprintf(stderr, "kernel_launch: hipFuncSetAttribute failed\n"); grid = -1; return; }
        if (hipOccupancyMaxActiveBlocksPerMultiprocessor(&per_cu, (const void*)mega, 512, LDS_BYTES) != hipSuccess || per_cu < 1) { fprintf(stderr, "kernel_launch: occupancy query gave %d\n", per_cu); per_cu = 1; }
        (void)hipGetLastError();
        grid = cus;
        fprintf(stderr, "kernel_launch: cus %d per_cu %d grid %d\n", cus, per_cu, grid);
    }
    if (grid < 0) return;
    Params p{};
    for (int i = 0; i < 22; ++i) p.in[i] = (const float*)d_in[i];
    p.out = (float*)d_out; p.ws = (unsigned char*)d_ws; p.ph_lo = 0; p.ph_hi = NPH; p.coop = 1; p.pad = 0;
    void* args[] = {&p};
    hipError_t e = hipLaunchCooperativeKernel((const void*)mega, dim3(grid), dim3(512), args, LDS_BYTES, stream);
    if (e != hipSuccess) fprintf(stderr, "kernel_launch: cooperative launch failed: %s (grid %d)\n", hipGetErrorString(e), grid);
}
```
